# Optimizing an MI355X kernel written in HIP

```python
import jax, jax.numpy as jnp
from jax import lax
import numpy as np

D_MODEL = 1024
BATCH = 8
SEQ = 2048
DEPTH = 1

MLA_HEADS = 8
Q_LORA_RANK = 384
KV_LORA_RANK = 128
QK_NOPE_DIM = 64
QK_ROPE_DIM = 32
V_HEAD_DIM = 64
QK_HEAD_DIM = QK_NOPE_DIM + QK_ROPE_DIM
MLA_WIDTH = MLA_HEADS * V_HEAD_DIM
Q_BLOCK = 128
ROPE_THETA = 10000.0
SGU_GROUPS = 8
SGU_GROUP_DIM = 64
SGU_WIDTH = SGU_GROUPS * SGU_GROUP_DIM
CHUNK = 128
RMS_EPS = 1e-6
LN_EPS = 1e-5
DN_ALPHA = (2.0 * DEPTH) ** 0.25
DN_BETA = (8.0 * DEPTH) ** -0.25
IN_SPLITS = (Q_LORA_RANK, KV_LORA_RANK, QK_ROPE_DIM, MLA_WIDTH,
             SGU_WIDTH, SGU_WIDTH, SGU_WIDTH, D_MODEL, D_MODEL)
IN_WIDTH = sum(IN_SPLITS)

kernel_name = "hybrid_mla_sgu_gated_deepnorm"


def rms_norm(x, g):
    xf = x.astype(jnp.float32)
    y = xf * lax.rsqrt(jnp.mean(xf * xf, axis=-1, keepdims=True) + RMS_EPS)
    return (y * g.astype(jnp.float32)).astype(x.dtype)


def layer_norm(x, g, b):
    xf = x.astype(jnp.float32)
    mu = jnp.mean(xf, axis=-1, keepdims=True)
    xc = xf - mu
    var = jnp.mean(xc * xc, axis=-1, keepdims=True)
    y = xc * lax.rsqrt(var + LN_EPS) * g.astype(jnp.float32) + b.astype(jnp.float32)
    return y.astype(x.dtype)


def rope_tables(positions):
    inv_freq = ROPE_THETA ** (-jnp.arange(0, QK_ROPE_DIM, 2, dtype=jnp.float32) / QK_ROPE_DIM)
    ang = positions.astype(jnp.float32)[..., None] * inv_freq
    return jnp.cos(ang)[:, :, None, :], jnp.sin(ang)[:, :, None, :]


def apply_rope(x, cos, sin):
    xf = x.astype(jnp.float32)
    half = QK_ROPE_DIM // 2
    x1, x2 = xf[..., :half], xf[..., half:]
    return jnp.concatenate([x1 * cos - x2 * sin, x2 * cos + x1 * sin], axis=-1).astype(x.dtype)


def split_columns(h):
    parts, start = [], 0
    for size in IN_SPLITS:
        parts.append(h[..., start:start + size])
        start += size
    return parts


def mla_attention(c_q, c_kv, k_pe, cos, sin, g_q, w_uq, g_kv, w_ukv):
    q = jnp.einsum('bsr,rhd->bshd', rms_norm(c_q, g_q), w_uq)
    q = jnp.concatenate([q[..., :QK_NOPE_DIM], apply_rope(q[..., QK_NOPE_DIM:], cos, sin)], axis=-1)
    kv = jnp.einsum('bsr,rhd->bshd', rms_norm(c_kv, g_kv), w_ukv)
    k_nope, v = kv[..., :QK_NOPE_DIM], kv[..., QK_NOPE_DIM:]
    k_pe = apply_rope(k_pe[:, :, None, :], cos, sin)
    k = jnp.concatenate([k_nope, jnp.broadcast_to(k_pe, k_nope.shape[:-1] + (QK_ROPE_DIM,))], axis=-1)
    scale = QK_HEAD_DIM ** -0.5
    seq = q.shape[1]
    outs = []
    for start in range(0, seq, Q_BLOCK):
        end = start + Q_BLOCK
        s = jnp.einsum('bqhd,bkhd->bhqk', q[:, start:end], k[:, :end]).astype(jnp.float32) * scale
        causal = jnp.arange(end)[None, :] <= (start + jnp.arange(Q_BLOCK))[:, None]
        p = jax.nn.softmax(jnp.where(causal, s, -jnp.inf), axis=-1)
        outs.append(jnp.einsum('bhqk,bkhd->bqhd', p.astype(v.dtype), v[:, :end]))
    o = jnp.concatenate(outs, axis=1)
    return o.reshape(o.shape[0], seq, MLA_WIDTH)


def spatial_gating(u, v, ln_g, ln_b, w_s, b_s):
    u = jax.nn.gelu(u)
    v = layer_norm(jax.nn.gelu(v), ln_g, ln_b)
    bsz, seq, _ = v.shape
    vc = v.reshape(bsz, seq // CHUNK, CHUNK, SGU_GROUPS, SGU_GROUP_DIM)
    mixed = jnp.einsum('gts,bcsgd->bctgd', jnp.tril(w_s), vc) + b_s.T[:, :, None]
    return u * mixed.reshape(bsz, seq, SGU_WIDTH)


def setup_inputs(seed: int = 0) -> dict:
    key = jax.random.key(seed)
    ks = jax.random.split(key, 17)
    nrm = jax.random.normal
    f32 = jnp.float32
    x = nrm(ks[0], (BATCH, SEQ, D_MODEL), f32)
    offset = jax.random.randint(ks[1], (BATCH, 1), 0, 4096, dtype=jnp.int32)
    positions = (offset + jnp.arange(SEQ, dtype=jnp.int32)[None, :]).astype(jnp.int32)
    w_in = nrm(ks[2], (DEPTH, D_MODEL, IN_WIDTH), f32) * D_MODEL ** -0.5
    b_in = 0.02 * nrm(ks[3], (DEPTH, IN_WIDTH), f32)
    g_q = 1.0 + 0.02 * nrm(ks[4], (DEPTH, Q_LORA_RANK), f32)
    w_uq = nrm(ks[5], (DEPTH, Q_LORA_RANK, MLA_HEADS, QK_HEAD_DIM), f32) * Q_LORA_RANK ** -0.5
    g_kv = 1.0 + 0.02 * nrm(ks[6], (DEPTH, KV_LORA_RANK), f32)
    w_ukv = nrm(ks[7], (DEPTH, KV_LORA_RANK, MLA_HEADS, QK_NOPE_DIM + V_HEAD_DIM), f32) * KV_LORA_RANK ** -0.5
    w_oa = nrm(ks[8], (DEPTH, MLA_WIDTH, D_MODEL), f32) * (MLA_WIDTH ** -0.5 * DN_BETA)
    sgu_ln_g = 1.0 + 0.02 * nrm(ks[9], (DEPTH, SGU_WIDTH), f32)
    sgu_ln_b = 0.02 * nrm(ks[10], (DEPTH, SGU_WIDTH), f32)
    w_s = nrm(ks[11], (DEPTH, SGU_GROUPS, CHUNK, CHUNK), f32) * CHUNK ** -0.5
    b_s = 1.0 + 0.02 * nrm(ks[12], (DEPTH, SGU_GROUPS, CHUNK), f32)
    w_ob = nrm(ks[13], (DEPTH, SGU_WIDTH, D_MODEL), f32) * (SGU_WIDTH ** -0.5 * DN_BETA)
    w_out = nrm(ks[14], (DEPTH, D_MODEL, D_MODEL), f32) * (D_MODEL ** -0.5 * DN_BETA)
    ln_g = 1.0 + 0.02 * nrm(ks[15], (DEPTH, D_MODEL), f32)
    ln_b = 0.02 * nrm(ks[16], (DEPTH, D_MODEL), f32)
    return {"x": x, "positions": positions, "w_in": w_in, "b_in": b_in,
            "g_q": g_q, "w_uq": w_uq, "g_kv": g_kv, "w_ukv": w_ukv, "w_oa": w_oa,
            "sgu_ln_g": sgu_ln_g, "sgu_ln_b": sgu_ln_b, "w_s": w_s, "b_s": b_s,
            "w_ob": w_ob, "w_out": w_out, "ln_g": ln_g, "ln_b": ln_b}


def reference(x, positions, w_in, b_in, g_q, w_uq, g_kv, w_ukv, w_oa,
              sgu_ln_g, sgu_ln_b, w_s, b_s, w_ob, w_out, ln_g, ln_b):
    cos, sin = rope_tables(positions)
    for l in range(DEPTH):
        h = jnp.einsum('bsd,dn->bsn', x, w_in[l]) + b_in[l]
        c_q, c_kv, k_pe, z_a, u, v, z_b, g_a, g_b = split_columns(h)
        y_a = mla_attention(c_q, c_kv, k_pe, cos, sin, g_q[l], w_uq[l], g_kv[l], w_ukv[l]) * jax.nn.silu(z_a)
        y_b = spatial_gating(u, v, sgu_ln_g[l], sgu_ln_b[l], w_s[l], b_s[l]) * jax.nn.silu(z_b)
        merged = (jax.nn.sigmoid(g_a) * jnp.einsum('bsc,cd->bsd', y_a, w_oa[l])
                  + jax.nn.sigmoid(g_b) * jnp.einsum('bsc,cd->bsd', y_b, w_ob[l]))
        x = layer_norm(DN_ALPHA * x + jnp.einsum('bsd,de->bse', merged, w_out[l]), ln_g[l], ln_b[l])
    return x
```

```cpp
#include <hip/hip_runtime.h>
#include <cstdint>
#include <cstdio>

typedef unsigned short bf16_t;

constexpr int BATCH = 8, SEQ = 2048, DM = 1024, M = BATCH * SEQ;
constexpr int NH = 8, QLR = 384, KVLR = 128, NOPE = 64, ROPE = 32, VHD = 64, QKD = 96, MLAW = 512;
constexpr int SGW = 512, CHUNK = 128, INW = 4640;
constexpr float RMS_EPS = 1e-6f, LN_EPS = 1e-5f;
constexpr float DN_ALPHA = 1.189207115002721f;
constexpr float QSCALE = 0.10206207261596577f * 1.4426950408889634f;

constexpr size_t MiB = 1u << 20;
constexpr size_t WS_CTL = 0;
constexpr size_t WS_WINT = 1 * MiB, WS_WUQT = 11 * MiB, WS_WUKVT = 12 * MiB, WS_WSB = 12 * MiB + 512 * 1024, WS_BIASP = 12 * MiB + 768 * 1024;
constexpr size_t WS_WOAT = 13 * MiB, WS_WOBT = 14 * MiB, WS_WOUTT = 15 * MiB, WS_COS = 17 * MiB, WS_SIN = 18 * MiB, WS_XCH = 19 * MiB, WS_STAT = 19 * MiB + 512 * 1024;
constexpr size_t WS_XB = 20 * MiB, WS_Q = 20 * MiB;
constexpr size_t WS_CQKV = 52 * MiB, WS_KPE = 68 * MiB, WS_ZA = 69 * MiB, WS_U = 85 * MiB, WS_YA = 85 * MiB;
constexpr size_t WS_GV = 101 * MiB, WS_ZB = 117 * MiB, WS_GA = 133 * MiB, WS_GB = 165 * MiB;
constexpr size_t WS_K = 197 * MiB, WS_V = 221 * MiB, WS_MG = 197 * MiB;
constexpr size_t WS_YB = 237 * MiB, WS_END = 253 * MiB;

struct Bufs {
    bf16_t *XB, *Q, *CQKV, *KPE, *ZA, *U, *YA, *GV, *ZB, *GA, *GB, *K, *V, *MG, *YB;
    float *COS, *SIN, *STAT;
};
static Bufs make_bufs(unsigned char* ws) {
    Bufs b;
    b.XB = (bf16_t*)(ws + WS_XB); b.Q = (bf16_t*)(ws + WS_Q); b.CQKV = (bf16_t*)(ws + WS_CQKV); b.KPE = (bf16_t*)(ws + WS_KPE); b.ZA = (bf16_t*)(ws + WS_ZA);
    b.U = (bf16_t*)(ws + WS_U); b.YA = (bf16_t*)(ws + WS_YA); b.GV = (bf16_t*)(ws + WS_GV); b.ZB = (bf16_t*)(ws + WS_ZB); b.GA = (bf16_t*)(ws + WS_GA); b.GB = (bf16_t*)(ws + WS_GB);
    b.K = (bf16_t*)(ws + WS_K); b.V = (bf16_t*)(ws + WS_V); b.MG = (bf16_t*)(ws + WS_MG); b.YB = (bf16_t*)(ws + WS_YB);
    b.COS = (float*)(ws + WS_COS); b.SIN = (float*)(ws + WS_SIN); b.STAT = (float*)(ws + WS_STAT);
    return b;
}

__device__ __forceinline__ float bf2f(bf16_t v) { return __uint_as_float((unsigned)v << 16); }
__device__ __forceinline__ bf16_t f2bf(float f) { unsigned u = __float_as_uint(f); return (bf16_t)((u + 0x7fffu + ((u >> 16) & 1u)) >> 16); }
__device__ __forceinline__ float sigmoid_f(float x) { return __builtin_amdgcn_rcpf(1.0f + __builtin_amdgcn_exp2f(-1.4426950408889634f * x)); }
__device__ __forceinline__ float silu_f(float x) { return x * sigmoid_f(x); }
__device__ __forceinline__ float gelu_tanh_f(float x) {
    const float y2 = 1.5957691216057308f * (x + 0.044715f * x * x * x);
    return x * sigmoid_f(y2);
}
__constant__ float INV_FREQ[16] = {1.0f, 0.5623413251903491f, 0.31622776601683794f, 0.17782794100389228f, 0.1f, 0.05623413251903491f, 0.03162277660168379f, 0.01778279410038923f,
                                   0.01f, 0.005623413251903491f, 0.0031622776601683794f, 0.0017782794100389228f, 0.001f, 0.0005623413251903491f, 0.00031622776601683794f, 0.00017782794100389228f};
__device__ __forceinline__ void sincos_rev(float a, float& s, float& c) {
    const float CH = 0.15915494309189535f, CL = (float)(0.15915494309189533576888 - (double)0.15915494309189535f);
    const float t = a * CH; float e = __builtin_fmaf(a, CH, -t); e = __builtin_fmaf(a, CL, e);
    const float fr = (t - __builtin_floorf(t)) + e;
    s = __builtin_amdgcn_sinf(fr); c = __builtin_amdgcn_cosf(fr);
}
__device__ __forceinline__ void rope_cs(int pos, int i, float& c, float& s) { const float ang = (float)pos * INV_FREQ[i]; sincos_rev(ang, s, c); }

__global__ void __launch_bounds__(256) n1_inproj(const float* __restrict__ x, const float* __restrict__ w_in, const float* __restrict__ b_in, Bufs B) {
    const int n = blockIdx.x * 256 + threadIdx.x;
    const int r0 = blockIdx.y * 8;
    if (n >= INW) return;
    float acc[8];
#pragma unroll
    for (int i = 0; i < 8; ++i) acc[i] = 0.f;
    for (int k = 0; k < DM; ++k) {
        const float w = w_in[(size_t)k * INW + n];
#pragma unroll
        for (int i = 0; i < 8; ++i) acc[i] = __builtin_fmaf(x[(size_t)(r0 + i) * DM + k], w, acc[i]);
    }
    const float bias = b_in[n];
#pragma unroll
    for (int i = 0; i < 8; ++i) {
        const size_t row = r0 + i; const float v = acc[i] + bias;
        if (n < 512) B.CQKV[row * 512 + n] = f2bf(v);
        else if (n < 544) B.KPE[row * 32 + (n - 512)] = f2bf(v);
        else if (n < 1056) B.ZA[row * 512 + (n - 544)] = f2bf(silu_f(v));
        else if (n < 1568) B.U[row * 512 + (n - 1056)] = f2bf(gelu_tanh_f(v));
        else if (n < 2080) B.GV[row * 512 + (n - 1568)] = f2bf(gelu_tanh_f(v));
        else if (n < 2592) B.ZB[row * 512 + (n - 2080)] = f2bf(silu_f(v));
        else if (n < 3616) B.GA[row * 1024 + (n - 2592)] = f2bf(sigmoid_f(v));
        else B.GB[row * 1024 + (n - 3616)] = f2bf(sigmoid_f(v));
    }
}
__global__ void __launch_bounds__(256) n2_stats(Bufs B) {
    const int row = blockIdx.x * 256 + threadIdx.x;
    float sq = 0.f, skv = 0.f;
    for (int k = 0; k < 384; ++k) { const float v = bf2f(B.CQKV[(size_t)row * 512 + k]); sq += v * v; }
    for (int k = 384; k < 512; ++k) { const float v = bf2f(B.CQKV[(size_t)row * 512 + k]); skv += v * v; }
    float mu = 0.f;
    for (int k = 0; k < 512; ++k) mu += bf2f(B.GV[(size_t)row * 512 + k]);
    mu *= (1.f / 512.f);
    float var = 0.f;
    for (int k = 0; k < 512; ++k) { const float d = bf2f(B.GV[(size_t)row * 512 + k]) - mu; var += d * d; }
    var *= (1.f / 512.f);
    B.STAT[row] = 1.0f / sqrtf(sq * (1.f / 384.f) + RMS_EPS);
    B.STAT[M + row] = 1.0f / sqrtf(skv * (1.f / 128.f) + RMS_EPS);
    B.STAT[2 * M + row] = mu;
    B.STAT[3 * M + row] = 1.0f / sqrtf(var + LN_EPS);
}
__global__ void __launch_bounds__(256) n2_q(const int* __restrict__ pos, const float* __restrict__ g_q, const float* __restrict__ w_uq, Bufs B) {
    const int n = blockIdx.x * 256 + threadIdx.x;
    const int row = blockIdx.y;
    const int d = n % 96;
    int n2 = n;
    if (d >= 64) n2 = (d < 80) ? n + 16 : n - 16;
    float a1 = 0.f, a2 = 0.f;
    for (int r = 0; r < QLR; ++r) {
        const float c = bf2f(B.CQKV[(size_t)row * 512 + r]) * g_q[r];
        a1 = __builtin_fmaf(c, w_uq[(size_t)r * 768 + n], a1);
        a2 = __builtin_fmaf(c, w_uq[(size_t)r * 768 + n2], a2);
    }
    const float rinv = B.STAT[row];
    a1 *= rinv; a2 *= rinv;
    float o = a1;
    if (d >= 64) {
        const int i = (d - 64) & 15; float c, s; rope_cs(pos[row], i, c, s);
        o = (d < 80) ? (a1 * c - a2 * s) : (a1 * c + a2 * s);
    }
    B.Q[(size_t)row * 768 + n] = f2bf(o * QSCALE);
}
__global__ void __launch_bounds__(256) n2_kv(const float* __restrict__ g_kv, const float* __restrict__ w_ukv, Bufs B) {
    const int n = blockIdx.x * 256 + threadIdx.x;
    const int row = blockIdx.y;
    float a = 0.f;
    for (int r = 0; r < KVLR; ++r) a = __builtin_fmaf(bf2f(B.CQKV[(size_t)row * 512 + 384 + r]) * g_kv[r], w_ukv[(size_t)r * 1024 + n], a);
    a *= B.STAT[M + row];
    const int h = n >> 7, e = n & 127;
    if (e < 64) B.K[(size_t)row * 768 + 96 * h + e] = f2bf(a);
    else B.V[(size_t)row * 512 + 64 * h + (e - 64)] = f2bf(a);
}
__global__ void __launch_bounds__(256) n2_kpe(const int* __restrict__ pos, Bufs B) {
    const int t = blockIdx.x * 256 + threadIdx.x;
    const int row = t >> 4, i = t & 15;
    const float x1 = bf2f(B.KPE[(size_t)row * 32 + i]), x2 = bf2f(B.KPE[(size_t)row * 32 + 16 + i]);
    float c, s; rope_cs(pos[row], i, c, s);
    const bf16_t o1 = f2bf(x1 * c - x2 * s), o2 = f2bf(x2 * c + x1 * s);
#pragma unroll
    for (int h = 0; h < NH; ++h) { B.K[(size_t)row * 768 + 96 * h + 64 + i] = o1; B.K[(size_t)row * 768 + 96 * h + 80 + i] = o2; }
}
__global__ void __launch_bounds__(256) n2_sgu(const float* __restrict__ lng, const float* __restrict__ lnb, const float* __restrict__ w_s, const float* __restrict__ b_s, Bufs B) {
    const int d = blockIdx.x * 256 + threadIdx.x;
    const int row = blockIdx.y;
    const int g = d >> 6, t = row & 127, r0 = row - t;
    const float gg = lng[d], bb = lnb[d];
    float acc = 0.f;
    for (int s = 0; s <= t; ++s) {
        const int rs = r0 + s;
        const float vn = (bf2f(B.GV[(size_t)rs * 512 + d]) - B.STAT[2 * M + rs]) * B.STAT[3 * M + rs] * gg + bb;
        acc = __builtin_fmaf(w_s[((size_t)g * 128 + t) * 128 + s], vn, acc);
    }
    acc += b_s[g * 128 + t];
    B.YB[(size_t)row * 512 + d] = f2bf(bf2f(B.U[(size_t)row * 512 + d]) * acc * bf2f(B.ZB[(size_t)row * 512 + d]));
}
__global__ void __launch_bounds__(64) n3_attn(Bufs B) {
    const int blk = blockIdx.x, qblk = blk & 31, bh = blk >> 5, h = bh & 7, b = bh >> 3;
    const int q = qblk * 64 + threadIdx.x; const size_t row = (size_t)b * SEQ + q;
    float qv[96], o[64];
#pragma unroll
    for (int d = 0; d < 96; ++d) qv[d] = bf2f(B.Q[row * 768 + 96 * h + d]);
#pragma unroll
    for (int d = 0; d < 64; ++d) o[d] = 0.f;
    float m = -INFINITY, l = 0.f;
    const int jmax = qblk * 64 + 63;
    for (int j = 0; j <= jmax; ++j) {
        const bf16_t* kr = B.K + ((size_t)b * SEQ + j) * 768 + 96 * h;
        const bf16_t* vr = B.V + ((size_t)b * SEQ + j) * 512 + 64 * h;
        float s = 0.f;
#pragma unroll
        for (int d = 0; d < 96; ++d) s = __builtin_fmaf(qv[d], bf2f(kr[d]), s);
        if (j > q) s = -INFINITY;
        const float mn = fmaxf(m, s), a = exp2f(m - mn), p = exp2f(s - mn);
        l = l * a + p;
#pragma unroll
        for (int d = 0; d < 64; ++d) o[d] = o[d] * a + p * bf2f(vr[d]);
        m = mn;
    }
    const float rl = 1.0f / l;
#pragma unroll
    for (int d = 0; d < 64; ++d) B.YA[row * 512 + 64 * h + d] = f2bf(o[d] * rl * bf2f(B.ZA[row * 512 + 64 * h + d]));
}
__global__ void __launch_bounds__(256) n4_merge(const float* __restrict__ w_oa, const float* __restrict__ w_ob, Bufs B) {
    const int n = blockIdx.x * 256 + threadIdx.x;
    const int r0 = blockIdx.y * 8;
    float a[8], c[8];
#pragma unroll
    for (int i = 0; i < 8; ++i) { a[i] = 0.f; c[i] = 0.f; }
    for (int k = 0; k < 512; ++k) {
        const float wa = w_oa[(size_t)k * 1024 + n], wb = w_ob[(size_t)k * 1024 + n];
#pragma unroll
        for (int i = 0; i < 8; ++i) { a[i] = __builtin_fmaf(bf2f(B.YA[(size_t)(r0 + i) * 512 + k]), wa, a[i]); c[i] = __builtin_fmaf(bf2f(B.YB[(size_t)(r0 + i) * 512 + k]), wb, c[i]); }
    }
#pragma unroll
    for (int i = 0; i < 8; ++i) { const size_t row = r0 + i; B.MG[row * 1024 + n] = f2bf(bf2f(B.GA[row * 1024 + n]) * a[i] + bf2f(B.GB[row * 1024 + n]) * c[i]); }
}
__global__ void __launch_bounds__(256) n5_out(const float* __restrict__ x, const float* __restrict__ w_out, const float* __restrict__ lng, const float* __restrict__ lnb, Bufs B, float* __restrict__ out) {
    __shared__ float red[8];
    const int row = blockIdx.x, tid = threadIdx.x;
    float v[4];
#pragma unroll
    for (int j = 0; j < 4; ++j) v[j] = 0.f;
    for (int k = 0; k < 1024; ++k) {
        const float mg = bf2f(B.MG[(size_t)row * 1024 + k]);
#pragma unroll
        for (int j = 0; j < 4; ++j) v[j] = __builtin_fmaf(mg, w_out[(size_t)k * 1024 + tid + 256 * j], v[j]);
    }
    float s = 0.f;
#pragma unroll
    for (int j = 0; j < 4; ++j) { v[j] += DN_ALPHA * x[(size_t)row * 1024 + tid + 256 * j]; s += v[j]; }
    for (int o = 32; o > 0; o >>= 1) s += __shfl_xor(s, o);
    if ((tid & 63) == 0) red[tid >> 6] = s;
    __syncthreads();
    const float mean = (red[0] + red[1] + red[2] + red[3]) * (1.f / 1024.f);
    float q = 0.f;
#pragma unroll
    for (int j = 0; j < 4; ++j) { const float d = v[j] - mean; q += d * d; }
    for (int o = 32; o > 0; o >>= 1) q += __shfl_xor(q, o);
    if ((tid & 63) == 0) red[4 + (tid >> 6)] = q;
    __syncthreads();
    const float rstd = 1.0f / sqrtf((red[4] + red[5] + red[6] + red[7]) * (1.f / 1024.f) + LN_EPS);
#pragma unroll
    for (int j = 0; j < 4; ++j) { const int c = tid + 256 * j; out[(size_t)row * 1024 + c] = (v[j] - mean) * rstd * lng[c] + lnb[c]; }
}

extern "C" void kernel_launch(void* const* d_in, const int* in_sizes, int n_in, void* d_out, int out_size, void* d_ws, size_t ws_size, hipStream_t stream) {
    if (n_in != 17 || ws_size < WS_END || out_size != M * DM) { fprintf(stderr, "kernel_launch: unexpected problem (n_in %d, ws %zu, out %d)\n", n_in, ws_size, out_size); return; }
    const float* x = (const float*)d_in[0]; const int* pos = (const int*)d_in[1];
    const float* w_in = (const float*)d_in[2]; const float* b_in = (const float*)d_in[3];
    const float* g_q = (const float*)d_in[4]; const float* w_uq = (const float*)d_in[5]; const float* g_kv = (const float*)d_in[6]; const float* w_ukv = (const float*)d_in[7];
    const float* w_oa = (const float*)d_in[8]; const float* sgu_g = (const float*)d_in[9]; const float* sgu_b = (const float*)d_in[10]; const float* w_s = (const float*)d_in[11];
    const float* b_s = (const float*)d_in[12]; const float* w_ob = (const float*)d_in[13]; const float* w_out = (const float*)d_in[14]; const float* ln_g = (const float*)d_in[15]; const float* ln_b = (const float*)d_in[16];
    Bufs B = make_bufs((unsigned char*)d_ws);
    n1_inproj<<<dim3((INW + 255) / 256, M / 8), 256, 0, stream>>>(x, w_in, b_in, B);
    n2_stats<<<M / 256, 256, 0, stream>>>(B);
    n2_q<<<dim3(3, M), 256, 0, stream>>>(pos, g_q, w_uq, B);
    n2_kv<<<dim3(4, M), 256, 0, stream>>>(g_kv, w_ukv, B);
    n2_kpe<<<M * 16 / 256, 256, 0, stream>>>(pos, B);
    n2_sgu<<<dim3(2, M), 256, 0, stream>>>(sgu_g, sgu_b, w_s, b_s, B);
    n3_attn<<<BATCH * NH * 32, 64, 0, stream>>>(B);
    n4_merge<<<dim3(4, M / 8), 256, 0, stream>>>(w_oa, w_ob, B);
    n5_out<<<M, 256, 0, stream>>>(x, w_out, ln_g, ln_b, B, (float*)d_out);
}
```
